# Optimizing an MI355X kernel written in HIP

```python
import math
import jax
import jax.numpy as jnp
from jax import lax
import numpy as np

D_MODEL = 1024
BATCH = 2
SEQ = 8192
DEPTH = 1

MIX_WIDTH = D_MODEL
FOX_WIDTH = MIX_WIDTH // 2
FOX_HEAD_DIM = 64
FOX_HEADS = FOX_WIDTH // FOX_HEAD_DIM
GLA_WIDTH = MIX_WIDTH - FOX_WIDTH
GLA_HEADS = 4
GLA_VAL_DIM = GLA_WIDTH // GLA_HEADS
GLA_KEY_DIM = GLA_VAL_DIM // 2
GLA_KEY_WIDTH = GLA_HEADS * GLA_KEY_DIM
GLA_GATE_RANK = 16
GLA_GATE_TEMP = 16.0
GLA_CHUNK = 64
Q_BLOCK = 128
D_FF = ((8 * D_MODEL // 3 + 255) // 256) * 256
LN_EPS = 1e-5
RMS_EPS = 1e-6
N_MOD = 6

DEEPNORM_ALPHA = (2.0 * DEPTH) ** 0.25
DEEPNORM_BETA = (8.0 * DEPTH) ** -0.25

IN_SPLITS = [
    FOX_WIDTH,
    FOX_WIDTH,
    FOX_WIDTH,
    FOX_HEADS,
    GLA_KEY_WIDTH,
    GLA_KEY_WIDTH,
    GLA_WIDTH,
    GLA_GATE_RANK,
    GLA_WIDTH,
]
IN_WIDTH = sum(IN_SPLITS)

kernel_name = "hymba_fox_gla_deepnorm_adaln_layer"


def layer_norm(x, g, b):
    xf = x.astype(jnp.float32)
    mu = jnp.mean(xf, axis=-1, keepdims=True)
    var = jnp.mean(jnp.square(xf - mu), axis=-1, keepdims=True)
    y = (xf - mu) * lax.rsqrt(var + LN_EPS)
    return (y * g.astype(jnp.float32) + b.astype(jnp.float32)).astype(x.dtype)


def fox_attention(q, k, v, f_logit, b_f):
    B, S, H, Dh = q.shape
    scale = 1.0 / math.sqrt(Dh)
    log_f = jax.nn.log_sigmoid((f_logit + b_f).astype(jnp.float32))
    dcum = jnp.cumsum(log_f, axis=1).transpose(0, 2, 1)
    qh = q.transpose(0, 2, 1, 3)
    kh = k.transpose(0, 2, 1, 3)
    vh = v.transpose(0, 2, 1, 3)
    nq = S // Q_BLOCK
    q_blocks = qh.reshape(B, H, nq, Q_BLOCK, Dh).transpose(2, 0, 1, 3, 4)
    d_blocks = dcum.reshape(B, H, nq, Q_BLOCK).transpose(2, 0, 1, 3)
    k_pos = jnp.arange(S)

    def one_block(args):
        qb, dqb, i = args
        s = jnp.einsum('bhqd,bhkd->bhqk', qb, kh).astype(jnp.float32) * scale
        s = s + dqb[..., None] - dcum[:, :, None, :]
        q_pos = i * Q_BLOCK + jnp.arange(Q_BLOCK)
        s = jnp.where(k_pos[None, :] <= q_pos[:, None], s, -1e30)
        p = jax.nn.softmax(s, axis=-1).astype(vh.dtype)
        return jnp.einsum('bhqk,bhkd->bhqd', p, vh)

    o = lax.map(one_block, (q_blocks, d_blocks, jnp.arange(nq)))
    return o.transpose(1, 0, 3, 2, 4).reshape(B, S, H * Dh)


def gla_attention(q, k, v, a_low, w_a2, b_a, r, g_norm):
    B, S, H, dk = q.shape
    dv = v.shape[-1]
    out_dtype = v.dtype
    C = GLA_CHUNK
    nc = S // C
    log_a = jax.nn.log_sigmoid((a_low @ w_a2 + b_a).astype(jnp.float32)) / GLA_GATE_TEMP
    log_a = log_a.reshape(B, S, H, dk)

    def chunks(t):
        return t.astype(jnp.float32).reshape(B, nc, C, H, -1).transpose(0, 3, 1, 2, 4)

    qc = chunks(q) * (dk ** -0.5)
    kc = chunks(k)
    vc = chunks(v)
    b = jnp.cumsum(chunks(log_a), axis=3)
    b_last = b[:, :, :, -1:, :]
    q_dec = qc * jnp.exp(b)
    k_inv = kc * jnp.exp(-b)
    k_to_end = kc * jnp.exp(b_last - b)
    causal = jnp.tril(jnp.ones((C, C), dtype=bool))
    a_intra = jnp.einsum('bhncd,bhnsd->bhncs', q_dec, k_inv)
    a_intra = jnp.where(causal, a_intra, 0.0)
    o_intra = jnp.einsum('bhncs,bhnse->bhnce', a_intra, vc)
    kv_chunk = jnp.einsum('bhncd,bhnce->bhnde', k_to_end, vc)
    decay = jnp.exp(b_last[:, :, :, 0, :])

    def step(state, inp):
        dec, kv = inp
        return dec[..., None] * state + kv, state

    init = jnp.zeros((B, H, dk, dv), jnp.float32)
    _, states = lax.scan(step, init, (decay.transpose(2, 0, 1, 3), kv_chunk.transpose(2, 0, 1, 3, 4)))
    states = states.transpose(1, 2, 0, 3, 4)
    o_inter = jnp.einsum('bhncd,bhnde->bhnce', q_dec, states)
    o = (o_intra + o_inter).transpose(0, 2, 3, 1, 4).reshape(B, S, H, dv)
    o = o * lax.rsqrt(jnp.mean(jnp.square(o), axis=-1, keepdims=True) + RMS_EPS)
    o = o.reshape(B, S, H * dv) * g_norm.astype(jnp.float32)
    return (o * jax.nn.silu(r.astype(jnp.float32))).astype(out_dtype)


def setup_inputs(seed: int = 0) -> dict:
    key = jax.random.key(seed)
    ks = jax.random.split(key, 17)
    f32 = jnp.float32
    nrm = lambda k, shape, s: (jax.random.normal(k, shape, f32) * s)
    return {
        "x": nrm(ks[0], (BATCH, SEQ, D_MODEL), 1.0),
        "c": nrm(ks[1], (BATCH, D_MODEL), 1.0),
        "w_c": nrm(ks[2], (D_MODEL, N_MOD * D_MODEL), 0.3 * D_MODEL ** -0.5),
        "b_c": nrm(ks[3], (N_MOD * D_MODEL,), 0.02),
        "w_in": nrm(ks[4], (D_MODEL, IN_WIDTH), D_MODEL ** -0.5),
        "b_f": nrm(ks[5], (FOX_HEADS,), 0.1),
        "w_a2": nrm(ks[6], (GLA_GATE_RANK, GLA_KEY_WIDTH), GLA_GATE_RANK ** -0.5),
        "b_a": nrm(ks[7], (GLA_KEY_WIDTH,), 0.1),
        "g_gla": 1.0 + nrm(ks[8], (GLA_WIDTH,), 0.02),
        "w_o": nrm(ks[9], (MIX_WIDTH, D_MODEL), DEEPNORM_BETA * MIX_WIDTH ** -0.5),
        "ln1_g": 1.0 + nrm(ks[10], (D_MODEL,), 0.02),
        "ln1_b": nrm(ks[11], (D_MODEL,), 0.02),
        "w_gate": nrm(ks[12], (D_MODEL, D_FF), D_MODEL ** -0.5),
        "w_up": nrm(ks[13], (D_MODEL, D_FF), D_MODEL ** -0.5),
        "w_down": nrm(ks[14], (D_FF, D_MODEL), DEEPNORM_BETA * D_FF ** -0.5),
        "ln2_g": 1.0 + nrm(ks[15], (D_MODEL,), 0.02),
        "ln2_b": nrm(ks[16], (D_MODEL,), 0.02),
    }


def reference(x, c, w_c, b_c, w_in, b_f, w_a2, b_a, g_gla, w_o, ln1_g, ln1_b,
              w_gate, w_up, w_down, ln2_g, ln2_b):
    B, S, D = x.shape
    mod = (c @ w_c + b_c).reshape(B, N_MOD, D)
    shift_m, scale_m, gate_m = mod[:, 0, None, :], mod[:, 1, None, :], mod[:, 2, None, :]
    shift_f, scale_f, gate_f = mod[:, 3, None, :], mod[:, 4, None, :], mod[:, 5, None, :]
    split_idx = list(np.cumsum(IN_SPLITS)[:-1])

    for _ in range(DEPTH):
        u = x * (1.0 + scale_m) + shift_m
        proj = u @ w_in
        fq, fk, fv, ff, gq, gk, gv, ga, gr = jnp.split(proj, split_idx, axis=-1)
        fox_out = fox_attention(
            fq.reshape(B, S, FOX_HEADS, FOX_HEAD_DIM),
            fk.reshape(B, S, FOX_HEADS, FOX_HEAD_DIM),
            fv.reshape(B, S, FOX_HEADS, FOX_HEAD_DIM),
            ff, b_f)
        gla_out = gla_attention(
            gq.reshape(B, S, GLA_HEADS, GLA_KEY_DIM),
            gk.reshape(B, S, GLA_HEADS, GLA_KEY_DIM),
            gv.reshape(B, S, GLA_HEADS, GLA_VAL_DIM),
            ga, w_a2, b_a, gr, g_gla)
        y = jnp.concatenate([fox_out, gla_out], axis=-1) @ w_o
        x = layer_norm(DEEPNORM_ALPHA * x + (1.0 + gate_m) * y, ln1_g, ln1_b)

        u2 = x * (1.0 + scale_f) + shift_f
        h = jax.nn.silu(u2 @ w_gate) * (u2 @ w_up)
        y2 = h @ w_down
        x = layer_norm(DEEPNORM_ALPHA * x + (1.0 + gate_f) * y2, ln2_g, ln2_b)
    return x
```

```cpp
#include <hip/hip_runtime.h>
#include <stdint.h>

typedef unsigned short bf16_t;
constexpr int NB = 2, S = 8192, D = 1024, M = NB * S;
constexpr int FH = 8, GH = 4, DFF = 2816, INW = 3096, PW = 3072;
constexpr int C_FF = 1536, C_GQ = 1544, C_GK = 1800, C_GV = 2056, C_GA = 2568, C_GR = 2584;
constexpr int P_FQ = 0, P_FK = 512, P_FV = 1024, P_GQ = 1536, P_GK = 1792, P_GV = 2048, P_GR = 2560;
constexpr float LOG2E = 1.4426950408889634f;
constexpr float C2 = 0.125f * LOG2E;
constexpr float ALPHA = 1.189207115002721f;
constexpr float LN_EPS = 1e-5f, RMS_EPS = 1e-6f;

constexpr size_t MiB = 1u << 20;
constexpr size_t WS_WIN = 1 * MiB, WS_WO = 7 * MiB, WS_WGU = 9 * MiB, WS_WD = 20 * MiB;
constexpr size_t WS_MOD = 26 * MiB;
constexpr size_t WS_FLOG = 26 * MiB + 65536;
constexpr size_t WS_ALOW = 27 * MiB;
constexpr size_t WS_DC = 28 * MiB;
constexpr size_t WS_U = 30 * MiB;
constexpr size_t WS_PROJ = 62 * MiB;
constexpr size_t WS_CAT = 158 * MiB;
constexpr size_t WS_X1 = 190 * MiB;
constexpr size_t WS_OGLA = 190 * MiB;
constexpr size_t WS_AG = 238 * MiB;

__device__ __forceinline__ float bf2f(bf16_t v) { return __uint_as_float(((unsigned)v) << 16); }
__device__ __forceinline__ bf16_t f2bf(float f) { unsigned u = __float_as_uint(f); return (bf16_t)((u + 0x7fffu + ((u >> 16) & 1u)) >> 16); }
__device__ __forceinline__ float log_sigmoid(float x) { return fminf(x, 0.f) - log1pf(expf(-fabsf(x))); }
__device__ __forceinline__ float wave_sum(float v) {
#pragma unroll
    for (int o = 1; o < 64; o <<= 1) v += __shfl_xor(v, o);
    return v;
}
__host__ __device__ __forceinline__ int win_col(int p) {
    return p < 1536 ? p : p < 1792 ? C_GQ + (p - 1536) : p < 2048 ? C_GK + (p - 1792) : p < 2560 ? C_GV + (p - 2048) : C_GR + (p - 2560);
}

__global__ void __launch_bounds__(256) k_mod(const float* c, const float* w_c, const float* b_c, float* mod) {
    const int j = blockIdx.x * 256 + threadIdx.x;
    float a0 = 0.f, a1 = 0.f;
    for (int k = 0; k < D; ++k) { const float w = w_c[(size_t)k * 6144 + j]; a0 += c[k] * w; a1 += c[D + k] * w; }
    mod[j] = a0 + b_c[j]; mod[6144 + j] = a1 + b_c[j];
}
__global__ void __launch_bounds__(256) k_wprep(const float* W, const float* W2, int K, int N, int ldw, int mode, bf16_t* WT) {
    const size_t idx = (size_t)blockIdx.x * 256 + threadIdx.x;
    if (idx >= (size_t)K * N) return;
    const int n = (int)(idx / K), k = (int)(idx % K);
    float v;
    if (mode == 0) v = W[(size_t)k * ldw + win_col(n)];
    else if (mode == 1) v = W[(size_t)k * ldw + n];
    else { const int t = n >> 8, r = n & 255; v = (r < 128 ? W : W2)[(size_t)k * ldw + t * 128 + (r & 127)]; }
    WT[idx] = f2bf(v);
}
__global__ void __launch_bounds__(256) k_u(const float* x, const float* mod, bf16_t* U) {
    const size_t idx = (size_t)blockIdx.x * 256 + threadIdx.x;
    const int m = (int)(idx >> 10), k = (int)(idx & 1023), b = m / S;
    const float* md = mod + b * 6144;
    U[idx] = f2bf(x[idx] * (1.f + md[1024 + k]) + md[k]);
}
__global__ void __launch_bounds__(256) k_skinny(const float* x, const float* mod, const float* w_in, const float* b_f, float* flog, float* alow) {
    const int idx = blockIdx.x * 256 + threadIdx.x;
    const int m = idx / 24, c = idx % 24, b = m / S;
    const int col = c < 8 ? C_FF + c : C_GA + (c - 8);
    const float* md = mod + b * 6144; const float* xr = x + (size_t)m * D;
    float a = 0.f;
    for (int k = 0; k < D; ++k) a += (xr[k] * (1.f + md[1024 + k]) + md[k]) * w_in[(size_t)k * INW + col];
    if (c < 8) flog[m * 8 + c] = log_sigmoid(a + b_f[c]); else alow[m * 16 + (c - 8)] = a;
}
template <int EPI> __global__ void __launch_bounds__(256) k_gemm(const bf16_t* A, const bf16_t* Bt, int K, float* outf, bf16_t* outb) {
    __shared__ float As[32][65], Bs[32][65], Bs2[32][65];
    const int tx = threadIdx.x & 15, ty = threadIdx.x >> 4;
    const int m0 = blockIdx.y * 64, n0 = blockIdx.x * 64;
    constexpr bool DUAL = (EPI == 2);
    float acc[4][4] = {}, acc2[4][4] = {};
    for (int k0 = 0; k0 < K; k0 += 32) {
        for (int i = 0; i < 8; ++i) {
            const int id = threadIdx.x + i * 256, r = id >> 5, cc = id & 31;
            As[cc][r] = bf2f(A[(size_t)(m0 + r) * K + k0 + cc]);
            const int n = n0 + r;
            const int brow = DUAL ? (256 * (n >> 7) + (n & 127)) : n;
            Bs[cc][r] = bf2f(Bt[(size_t)brow * K + k0 + cc]);
            if (DUAL) Bs2[cc][r] = bf2f(Bt[(size_t)(brow + 128) * K + k0 + cc]);
        }
        __syncthreads();
        for (int kk = 0; kk < 32; ++kk) {
            float a[4], b[4], b2[4];
            for (int i = 0; i < 4; ++i) { a[i] = As[kk][ty * 4 + i]; b[i] = Bs[kk][tx * 4 + i]; b2[i] = DUAL ? Bs2[kk][tx * 4 + i] : 0.f; }
            for (int i = 0; i < 4; ++i) for (int j = 0; j < 4; ++j) { acc[i][j] += a[i] * b[j]; if (DUAL) acc2[i][j] += a[i] * b2[j]; }
        }
        __syncthreads();
    }
    for (int i = 0; i < 4; ++i) for (int j = 0; j < 4; ++j) {
        const int m = m0 + ty * 4 + i, n = n0 + tx * 4 + j; const float v = acc[i][j];
        if (EPI == 0) outb[(size_t)m * PW + n] = f2bf(n < 512 ? v * C2 : v);
        else if (EPI == 1) outf[(size_t)m * D + n] = v;
        else { const float g = v, u = acc2[i][j]; outb[(size_t)m * DFF + n] = f2bf(g / (1.f + expf(-g)) * u); }
    }
}
__global__ void __launch_bounds__(64) k_dcum(const float* flog, float* dc) {
    const int bh = threadIdx.x;  if (bh >= 16) return;
    const int b = bh >> 3, h = bh & 7; double a = 0.0;
    for (int t = 0; t < S; ++t) { a += (double)flog[((size_t)b * S + t) * 8 + h]; dc[(size_t)bh * S + t] = (float)a; }
}
__global__ void __launch_bounds__(256) k_attn_naive(const bf16_t* proj, const float* dc, bf16_t* cat) {
    const int gw = (blockIdx.x * 256 + threadIdx.x) >> 6, lane = threadIdx.x & 63;
    const int bh = gw / (S / 64), qb = gw % (S / 64), b = bh >> 3, h = bh & 7;
    const int q = qb * 64 + lane; const size_t row = (size_t)b * S + q;
    float qv[64], o[64];
    for (int d = 0; d < 64; ++d) { qv[d] = bf2f(proj[row * PW + P_FQ + h * 64 + d]); o[d] = 0.f; }
    const float dq = dc[(size_t)bh * S + q] * LOG2E;
    float mrun = -1e30f, l = 0.f;
    for (int k = 0; k <= qb * 64 + 63; ++k) {
        const bf16_t* kr = proj + ((size_t)b * S + k) * PW + P_FK + h * 64;
        const bf16_t* vr = proj + ((size_t)b * S + k) * PW + P_FV + h * 64;
        float s = 0.f;
        for (int d = 0; d < 64; ++d) s += qv[d] * bf2f(kr[d]);
        s += dq - dc[(size_t)bh * S + k] * LOG2E;
        if (k > q) s = -1e30f;
        const float mn = fmaxf(mrun, s), al = exp2f(mrun - mn), p = (k > q) ? 0.f : exp2f(s - mn);
        l = l * al + p; mrun = mn;
        for (int d = 0; d < 64; ++d) o[d] = o[d] * al + p * bf2f(vr[d]);
    }
    const float rl = 1.f / l;
    for (int d = 0; d < 64; ++d) cat[row * D + h * 64 + d] = f2bf(o[d] * rl);
}
__global__ void __launch_bounds__(256) k_gla_gate(const float* alow, const float* w_a2, const float* b_a, float* ag) {
    const size_t idx = (size_t)blockIdx.x * 256 + threadIdx.x;
    const int m = (int)(idx >> 8), j = (int)(idx & 255);
    float a = b_a[j];
    for (int r = 0; r < 16; ++r) a += alow[m * 16 + r] * w_a2[r * 256 + j];
    ag[idx] = expf(log_sigmoid(a) * (1.f / 16.f));
}
__global__ void __launch_bounds__(128) k_gla_rec(const bf16_t* proj, const float* ag, float* ogla) {
    const int bh = blockIdx.x, b = bh >> 2, h = bh & 3, e = threadIdx.x;
    float st[64];
    for (int d = 0; d < 64; ++d) st[d] = 0.f;
    for (int t = 0; t < S; ++t) {
        const size_t row = (size_t)b * S + t;
        const bf16_t* pr = proj + row * PW;
        const float v = bf2f(pr[P_GV + h * 128 + e]);
        const float* a = ag + row * 256 + h * 64;
        float o = 0.f;
        for (int d = 0; d < 64; ++d) { st[d] = a[d] * st[d] + bf2f(pr[P_GK + h * 64 + d]) * v; o += bf2f(pr[P_GQ + h * 64 + d]) * st[d]; }
        ogla[row * 512 + h * 128 + e] = o * 0.125f;
    }
}
__global__ void __launch_bounds__(256) k_gla_norm(const float* ogla, const bf16_t* proj, const float* g_gla, bf16_t* cat) {
    const int gw = (blockIdx.x * 256 + threadIdx.x) >> 6, lane = threadIdx.x & 63;
    const int m = gw >> 2, h = gw & 3;
    const float o0 = ogla[(size_t)m * 512 + h * 128 + lane], o1 = ogla[(size_t)m * 512 + h * 128 + 64 + lane];
    const float ms = wave_sum(o0 * o0 + o1 * o1) * (1.f / 128.f), rs = 1.f / sqrtf(ms + RMS_EPS);
    for (int j = 0; j < 2; ++j) { const int e = h * 128 + j * 64 + lane; const float r = bf2f(proj[(size_t)m * PW + P_GR + e]);
        cat[(size_t)m * D + 512 + e] = f2bf((j ? o1 : o0) * rs * g_gla[e] * (r / (1.f + expf(-r)))); }
}
__global__ void __launch_bounds__(256) k_ln(const float* res, const float* y, const float* mod, int gate_i, const float* g, const float* bb, float* out, bf16_t* u2, int scale_i, int shift_i) {
    const int m = (blockIdx.x * 256 + threadIdx.x) >> 6, lane = threadIdx.x & 63, b = m / S;
    const float* md = mod + b * 6144;
    float t[16]; float s = 0.f;
    for (int j = 0; j < 16; ++j) { const int k = j * 64 + lane; t[j] = ALPHA * res[(size_t)m * D + k] + (1.f + md[gate_i * 1024 + k]) * y[(size_t)m * D + k]; s += t[j]; }
    const float mean = wave_sum(s) * (1.f / D); float q = 0.f;
    for (int j = 0; j < 16; ++j) { t[j] -= mean; q += t[j] * t[j]; }
    const float rstd = 1.f / sqrtf(wave_sum(q) * (1.f / D) + LN_EPS);
    for (int j = 0; j < 16; ++j) { const int k = j * 64 + lane; const float v = t[j] * rstd * g[k] + bb[k]; out[(size_t)m * D + k] = v;
        if (u2) u2[(size_t)m * D + k] = f2bf(v * (1.f + md[scale_i * 1024 + k]) + md[shift_i * 1024 + k]); }
}

extern "C" void kernel_launch(void* const* d_in, const int* in_sizes, int n_in, void* d_out, int out_size, void* d_ws, size_t ws_size, hipStream_t stream) {
    const float* x = (const float*)d_in[0]; const float* c = (const float*)d_in[1]; const float* w_c = (const float*)d_in[2]; const float* b_c = (const float*)d_in[3];
    const float* w_in = (const float*)d_in[4]; const float* b_f = (const float*)d_in[5]; const float* w_a2 = (const float*)d_in[6]; const float* b_a = (const float*)d_in[7];
    const float* g_gla = (const float*)d_in[8]; const float* w_o = (const float*)d_in[9]; const float* ln1_g = (const float*)d_in[10]; const float* ln1_b = (const float*)d_in[11];
    const float* w_gate = (const float*)d_in[12]; const float* w_up = (const float*)d_in[13]; const float* w_down = (const float*)d_in[14];
    const float* ln2_g = (const float*)d_in[15]; const float* ln2_b = (const float*)d_in[16];
    unsigned char* ws = (unsigned char*)d_ws; float* out = (float*)d_out;
    bf16_t* WinT = (bf16_t*)(ws + WS_WIN); bf16_t* WoT = (bf16_t*)(ws + WS_WO); bf16_t* WguT = (bf16_t*)(ws + WS_WGU); bf16_t* WdT = (bf16_t*)(ws + WS_WD);
    float* mod = (float*)(ws + WS_MOD); float* flog = (float*)(ws + WS_FLOG); float* alow = (float*)(ws + WS_ALOW); float* dc = (float*)(ws + WS_DC);
    bf16_t* U = (bf16_t*)(ws + WS_U); bf16_t* PROJ = (bf16_t*)(ws + WS_PROJ); bf16_t* H = (bf16_t*)(ws + WS_PROJ); bf16_t* CAT = (bf16_t*)(ws + WS_CAT);
    float* X1 = (float*)(ws + WS_X1); float* OGLA = (float*)(ws + WS_OGLA); float* AG = (float*)(ws + WS_AG);

    k_mod<<<6144 / 256, 256, 0, stream>>>(c, w_c, b_c, mod);
    k_wprep<<<(PW * D) / 256, 256, 0, stream>>>(w_in, nullptr, D, PW, INW, 0, WinT);
    k_wprep<<<(D * D) / 256, 256, 0, stream>>>(w_o, nullptr, D, D, D, 1, WoT);
    k_wprep<<<(2 * DFF * D) / 256, 256, 0, stream>>>(w_gate, w_up, D, 2 * DFF, DFF, 2, WguT);
    k_wprep<<<(D * DFF) / 256, 256, 0, stream>>>(w_down, nullptr, DFF, D, D, 1, WdT);
    k_u<<<(M * D) / 256, 256, 0, stream>>>(x, mod, U);
    k_skinny<<<(M * 24) / 256, 256, 0, stream>>>(x, mod, w_in, b_f, flog, alow);
    k_gemm<0><<<dim3(PW / 64, M / 64), 256, 0, stream>>>(U, WinT, D, nullptr, PROJ);
    k_dcum<<<1, 64, 0, stream>>>(flog, dc);
    k_attn_naive<<<(16 * S) / 256, 256, 0, stream>>>(PROJ, dc, CAT);
    k_gla_gate<<<(M * 256) / 256, 256, 0, stream>>>(alow, w_a2, b_a, AG);
    k_gla_rec<<<8, 128, 0, stream>>>(PROJ, AG, OGLA);
    k_gla_norm<<<(M * 4 * 64) / 256, 256, 0, stream>>>(OGLA, PROJ, g_gla, CAT);
    k_gemm<1><<<dim3(D / 64, M / 64), 256, 0, stream>>>(CAT, WoT, D, X1, nullptr);
    k_ln<<<(M * 64) / 256, 256, 0, stream>>>(x, X1, mod, 2, ln1_g, ln1_b, X1, U, 4, 3);
    k_gemm<2><<<dim3(DFF / 64, M / 64), 256, 0, stream>>>(U, WguT, D, nullptr, H);
    k_gemm<1><<<dim3(D / 64, M / 64), 256, 0, stream>>>(H, WdT, DFF, out, nullptr);
    k_ln<<<(M * 64) / 256, 256, 0, stream>>>(X1, out, mod, 5, ln2_g, ln2_b, out, nullptr, 0, 0);
}
```
